# Optimizing an MI355X kernel written in HIP

```python
import math
import jax, jax.numpy as jnp
from jax import lax
import numpy as np

D_MODEL = 1024
BATCH = 8
SEQ = 2048
DEPTH = 1
DEC_BATCH = 32
DEC_SEQ = 16
PAST_LEN = 1024

CHUNK = 64
HEAD_DIM = 64
N_Q_HEADS = (D_MODEL // 2) // HEAD_DIM
N_KV_HEADS = 2
GQA_GROUP = N_Q_HEADS // N_KV_HEADS
WINDOW = 128
WIN_CHUNKS = WINDOW // CHUNK
ATTN_WIDTH = N_Q_HEADS * HEAD_DIM
KV_WIDTH = N_KV_HEADS * HEAD_DIM
POOL_WINDOWS = (2, 4, 8, 16)
N_POOL_GROUPS = len(POOL_WINDOWS)
POOL_WIDTH = D_MODEL // 2
POOL_GROUP_WIDTH = POOL_WIDTH // N_POOL_GROUPS
POOL_PAD = max(POOL_WINDOWS) - 1
MIX_WIDTH = ATTN_WIDTH + POOL_WIDTH
IN_WIDTH = ATTN_WIDTH + 2 * KV_WIDTH + POOL_WIDTH
D_FF = ((8 * D_MODEL + 3 * 256 - 1) // (3 * 256)) * 256
PLE_DIM = 256
N_BUCKETS = 32
MAX_DISTANCE = 128
RMS_EPS = 1e-6
MASK_VALUE = -1e30

kernel_name = "hybrid_swa_sink_pool_stream_step"


def _rmsnorm(x, g):
    xf = x.astype(jnp.float32)
    y = xf * lax.rsqrt(jnp.mean(xf * xf, axis=-1, keepdims=True) + RMS_EPS)
    return (y * g.astype(jnp.float32)).astype(x.dtype)


def _t5_bucket(rel):
    half = N_BUCKETS // 2
    max_exact = half // 2
    ret = jnp.where(rel > 0, half, 0)
    n = jnp.abs(rel)
    nf = jnp.maximum(n, 1).astype(jnp.float32)
    large = max_exact + (jnp.log(nf / max_exact) / math.log(MAX_DISTANCE / max_exact)
                         * (half - max_exact)).astype(jnp.int32)
    large = jnp.minimum(large, half - 1)
    return ret + jnp.where(n < max_exact, n, large)


def _rel_bias(q_pos, k_pos, table):
    b = table[_t5_bucket(k_pos[None, :] - q_pos[:, None])].astype(jnp.float32)
    b = jnp.transpose(b, (2, 0, 1))
    return b.reshape(N_KV_HEADS, GQA_GROUP, q_pos.shape[0], k_pos.shape[0])


def _sink_attention(q, k, v, bias, valid, sinks):
    s = jnp.einsum('bnqkgd,bnskd->bnkgqs', q.astype(jnp.float32), k.astype(jnp.float32))
    s = s * (HEAD_DIM ** -0.5) + bias[None, None]
    s = jnp.where(valid[None, :, None, None, None, :], s, MASK_VALUE)
    sk = sinks.astype(jnp.float32).reshape(N_KV_HEADS, GQA_GROUP)[None, None, :, :, None, None]
    m = jnp.maximum(jnp.max(s, axis=-1, keepdims=True), sk)
    p = jnp.exp(s - m)
    w = p / (jnp.sum(p, axis=-1, keepdims=True) + jnp.exp(sk - m))
    return jnp.einsum('bnkgqs,bnskd->bnqkgd', w.astype(v.dtype), v)


def _prompt_attention(q, k, v, table, sinks):
    B, S, _ = q.shape
    nc = S // CHUNK
    nk = (WIN_CHUNKS + 1) * CHUNK
    qb = q.reshape(B, nc, CHUNK, N_KV_HEADS, GQA_GROUP, HEAD_DIM)
    pad = ((0, 0), (WIN_CHUNKS, 0), (0, 0), (0, 0), (0, 0))
    kp = jnp.pad(k.reshape(B, nc, CHUNK, N_KV_HEADS, HEAD_DIM), pad)
    vp = jnp.pad(v.reshape(B, nc, CHUNK, N_KV_HEADS, HEAD_DIM), pad)
    kb = jnp.concatenate([kp[:, w:w + nc] for w in range(WIN_CHUNKS + 1)], axis=2)
    vb = jnp.concatenate([vp[:, w:w + nc] for w in range(WIN_CHUNKS + 1)], axis=2)
    q_pos = jnp.arange(CHUNK, dtype=jnp.int32)
    k_pos = jnp.arange(nk, dtype=jnp.int32) - WIN_CHUNKS * CHUNK
    bias = _rel_bias(q_pos, k_pos, table)
    valid = (jnp.arange(nc, dtype=jnp.int32)[:, None] * CHUNK + k_pos[None, :]) >= 0
    o = _sink_attention(qb, kb, vb, bias, valid, sinks)
    return o.reshape(B, S, ATTN_WIDTH)


def _sample_attention(q, k, v, cache_k, cache_v, table, sinks):
    B, L, _ = q.shape
    n_past = cache_k.shape[1]
    qb = q.reshape(B, 1, L, N_KV_HEADS, GQA_GROUP, HEAD_DIM)
    kb = jnp.concatenate([cache_k, k.reshape(B, L, N_KV_HEADS, HEAD_DIM)], axis=1)[:, None]
    vb = jnp.concatenate([cache_v, v.reshape(B, L, N_KV_HEADS, HEAD_DIM)], axis=1)[:, None]
    q_pos = PAST_LEN + jnp.arange(L, dtype=jnp.int32)
    k_pos = PAST_LEN - n_past + jnp.arange(n_past + L, dtype=jnp.int32)
    bias = _rel_bias(q_pos, k_pos, table)
    valid = (k_pos >= 0)[None, :]
    o = _sink_attention(qb, kb, vb, bias, valid, sinks)
    return o.reshape(B, L, ATTN_WIDTH)


def _multiscale_pool(ext, pos, w_pool, scale):
    L = pos.shape[0]
    cs = jnp.pad(jnp.cumsum(ext.astype(jnp.float32), axis=1), ((0, 0), (1, 0), (0, 0)))
    u = ext[:, POOL_PAD:].astype(jnp.float32)
    outs = []
    for g, w in enumerate(POOL_WINDOWS):
        sl = slice(g * POOL_GROUP_WIDTH, (g + 1) * POOL_GROUP_WIDTH)
        total = cs[:, POOL_PAD + 1:POOL_PAD + 1 + L, sl] - cs[:, POOL_PAD + 1 - w:POOL_PAD + 1 - w + L, sl]
        count = jnp.minimum(pos + 1, w).astype(jnp.float32)[None, :, None]
        diff = (total / count - u[..., sl]).astype(ext.dtype)
        outs.append(jnp.einsum('bld,de->ble', diff, w_pool[g]))
    return jnp.concatenate(outs, axis=-1) * scale


def _split_proj(x, g_mix_pre, w_in):
    z = _rmsnorm(x, g_mix_pre) @ w_in
    q, k, v, u = jnp.split(z, [ATTN_WIDTH, ATTN_WIDTH + KV_WIDTH, ATTN_WIDTH + 2 * KV_WIDTH], axis=-1)
    return q, k, v, u


def _finish_layer(x, attn, pool, pe, w_out, g_mix_post, g_ffn_pre, w_ffn_gate, w_ffn_up,
                  w_ffn_down, g_ffn_post, w_ple, w_ple_gate):
    mix = jnp.concatenate([attn, pool.astype(attn.dtype)], axis=-1) @ w_out
    x = x + _rmsnorm(mix, g_mix_post)
    h = _rmsnorm(x, g_ffn_pre)
    f = (jax.nn.silu(h @ w_ffn_gate) * (h @ w_ffn_up)) @ w_ffn_down
    x = x + _rmsnorm(f, g_ffn_post)
    return x + jax.nn.sigmoid(x @ w_ple_gate) * (pe @ w_ple)


def setup_inputs(seed: int = 0) -> dict:
    key = jax.random.key(seed)
    ks = jax.random.split(key, 24)
    nrm = lambda k, shape, s=1.0: jax.random.normal(k, shape, jnp.float32) * s
    win_rows = min(WINDOW, PAST_LEN)
    return {
        "x_prompt": nrm(ks[0], (BATCH, SEQ, D_MODEL)),
        "x_sample": nrm(ks[1], (DEC_BATCH, DEC_SEQ, D_MODEL)),
        "cache_k": nrm(ks[2], (DEPTH, DEC_BATCH, win_rows, N_KV_HEADS, HEAD_DIM)),
        "cache_v": nrm(ks[3], (DEPTH, DEC_BATCH, win_rows, N_KV_HEADS, HEAD_DIM)),
        "state_pool": nrm(ks[4], (DEPTH, DEC_BATCH, POOL_PAD, POOL_WIDTH)),
        "p_prompt": nrm(ks[5], (DEPTH, BATCH, SEQ, PLE_DIM)),
        "p_sample": nrm(ks[6], (DEPTH, DEC_BATCH, DEC_SEQ, PLE_DIM)),
        "rel_bias_table": nrm(ks[7], (N_BUCKETS, N_Q_HEADS), 0.5),
        "g_mix_pre": 1.0 + nrm(ks[8], (DEPTH, D_MODEL), 0.05),
        "w_in": nrm(ks[9], (DEPTH, D_MODEL, IN_WIDTH), D_MODEL ** -0.5),
        "attn_sinks": nrm(ks[10], (DEPTH, N_Q_HEADS), 0.5),
        "w_pool": nrm(ks[11], (DEPTH, N_POOL_GROUPS, POOL_GROUP_WIDTH, POOL_GROUP_WIDTH), POOL_GROUP_WIDTH ** -0.5),
        "pool_scale": 1.0 + nrm(ks[12], (DEPTH, POOL_WIDTH), 0.05),
        "w_out": nrm(ks[13], (DEPTH, MIX_WIDTH, D_MODEL), MIX_WIDTH ** -0.5),
        "g_mix_post": 1.0 + nrm(ks[14], (DEPTH, D_MODEL), 0.05),
        "g_ffn_pre": 1.0 + nrm(ks[15], (DEPTH, D_MODEL), 0.05),
        "w_ffn_gate": nrm(ks[16], (DEPTH, D_MODEL, D_FF), D_MODEL ** -0.5),
        "w_ffn_up": nrm(ks[17], (DEPTH, D_MODEL, D_FF), D_MODEL ** -0.5),
        "w_ffn_down": nrm(ks[18], (DEPTH, D_FF, D_MODEL), D_FF ** -0.5),
        "g_ffn_post": 1.0 + nrm(ks[19], (DEPTH, D_MODEL), 0.05),
        "w_ple": nrm(ks[20], (DEPTH, PLE_DIM, D_MODEL), PLE_DIM ** -0.5),
        "w_ple_gate": nrm(ks[21], (DEPTH, D_MODEL, D_MODEL), D_MODEL ** -0.5),
    }


def reference(x_prompt, x_sample, cache_k, cache_v, state_pool, p_prompt, p_sample, rel_bias_table,
              g_mix_pre, w_in, attn_sinks, w_pool, pool_scale, w_out, g_mix_post, g_ffn_pre,
              w_ffn_gate, w_ffn_up, w_ffn_down, g_ffn_post, w_ple, w_ple_gate):
    xp, xs = x_prompt, x_sample
    S = xp.shape[1]
    L = xs.shape[1]
    win_prompt = min(WINDOW, S)
    pos_prompt = jnp.arange(S, dtype=jnp.int32)
    pos_sample = PAST_LEN + jnp.arange(L, dtype=jnp.int32)
    kp_list, vp_list, up_list, ks_list, vs_list, us_list = [], [], [], [], [], []
    for i in range(DEPTH):
        q, k, v, u = _split_proj(xp, g_mix_pre[i], w_in[i])
        a = _prompt_attention(q, k, v, rel_bias_table, attn_sinks[i])
        ext = jnp.pad(u, ((0, 0), (POOL_PAD, 0), (0, 0)))
        pl = _multiscale_pool(ext, pos_prompt, w_pool[i], pool_scale[i])
        kp_list.append(k.reshape(k.shape[0], S, N_KV_HEADS, HEAD_DIM)[:, S - win_prompt:])
        vp_list.append(v.reshape(v.shape[0], S, N_KV_HEADS, HEAD_DIM)[:, S - win_prompt:])
        up_list.append(u[:, S - POOL_PAD:])
        xp = _finish_layer(xp, a, pl, p_prompt[i], w_out[i], g_mix_post[i], g_ffn_pre[i],
                           w_ffn_gate[i], w_ffn_up[i], w_ffn_down[i], g_ffn_post[i], w_ple[i], w_ple_gate[i])
        q, k, v, u = _split_proj(xs, g_mix_pre[i], w_in[i])
        a = _sample_attention(q, k, v, cache_k[i], cache_v[i], rel_bias_table, attn_sinks[i])
        ext = jnp.concatenate([state_pool[i].astype(u.dtype), u], axis=1)
        pl = _multiscale_pool(ext, pos_sample, w_pool[i], pool_scale[i])
        ks_list.append(k.reshape(k.shape[0], L, N_KV_HEADS, HEAD_DIM))
        vs_list.append(v.reshape(v.shape[0], L, N_KV_HEADS, HEAD_DIM))
        us_list.append(ext[:, ext.shape[1] - POOL_PAD:])
        xs = _finish_layer(xs, a, pl, p_sample[i], w_out[i], g_mix_post[i], g_ffn_pre[i],
                           w_ffn_gate[i], w_ffn_up[i], w_ffn_down[i], g_ffn_post[i], w_ple[i], w_ple_gate[i])
    new_k_prompt = jnp.stack(kp_list)
    new_v_prompt = jnp.stack(vp_list)
    new_pool_prompt = jnp.stack(up_list)
    new_k_sample = jnp.stack(ks_list)
    new_v_sample = jnp.stack(vs_list)
    new_pool_sample = jnp.stack(us_list)
    return (xp, xs, new_k_prompt, new_v_prompt, new_pool_prompt, new_k_sample, new_v_sample, new_pool_sample)
```

```cpp
#include <hip/hip_runtime.h>
#include <cstdio>
#include <cstdint>

constexpr int DM = 1024, MP = 16384, MS = 512, M = MP + MS;
constexpr int NIN = 1280, DFF = 2816, NGU = 2 * DFF, PLE = 256;
constexpr int SEQ = 2048, NB_P = 8, NB_S = 32, LS = 16, NPAST = 128, SKEYS = NPAST + LS;
constexpr int KROWS = MP + NB_S * SKEYS + 64;
constexpr float RMS_EPS = 1e-6f;
constexpr float LOG2E = 1.4426950408889634f;
constexpr float QSCALE = 0.125f * LOG2E;
constexpr size_t O_Y = 0, O_KP = (size_t)M * DM, O_VP = O_KP + 131072, O_PP = O_VP + 131072, O_KS = O_PP + 61440, O_VS = O_KS + 65536, O_PS = O_VS + 65536;

namespace pg8 {
#define PG8_LAS __attribute__((address_space(3)))
typedef unsigned short bf16_t;
typedef short bf16x8 __attribute__((ext_vector_type(8)));
typedef float f32x4 __attribute__((ext_vector_type(4)));
typedef unsigned u32x4 __attribute__((ext_vector_type(4)));
constexpr int BM = 256, BK = 64, HALF = 128, HTB = HALF * BK * 2  , STAGE_BYTES = 8 * HTB, NXCD = 8, WGM = 8;

__host__ __device__ __forceinline__ int lds_byte(int r, int c) { const int st = (r >> 4) * 2 + (c >> 5), rr = r & 15, cc = c & 31, ob = rr * 64 + cc * 2; return st * 1024 + (ob ^ (((ob >> 9) & 1) << 5)); }
__host__ __device__ __forceinline__ void stage_rc(int b, int& R, int& C) { const int st = b / 1024, sb = b % 1024, swz = sb ^ (((sb >> 9) & 1) << 5); R = (st >> 1) * 16 + swz / 64; C = (st & 1) * 32 + (swz % 64) / 2; }
__host__ __device__ __forceinline__ int perm32(int rho) { const int n = rho >> 4, i = rho & 15; return 8 * (i >> 2) + 4 * n + (i & 3); }

struct Unit { int pm, pn; };
struct Gemm { const bf16_t* A; const bf16_t* Bt; int M, N, K; };

struct StaticOrder {
    int nM, nN, nwg, G, c;
    __host__ __device__ void init(int M, int N, int G_, int c_) { nM = M / BM; nN = N / BM; nwg = nM * nN; G = G_; c = c_; }
    __host__ __device__ bool next(int i, Unit& u) const {
        const long L = (long)i * G + c; if (L >= nwg) return false;
        int wgid = (int)L; { const int q = nwg / NXCD, r = nwg % NXCD, xcd = wgid % NXCD, off = wgid / NXCD; wgid = (xcd < r ? xcd * (q + 1) : r * (q + 1) + (xcd - r) * q) + off; }
        const int nig = WGM * nN, gid = wgid / nig, fm = gid * WGM, gsz = (nM - fm) < WGM ? (nM - fm) : WGM;
        u.pm = fm + ((wgid % nig) % gsz); u.pn = (wgid % nig) / gsz; return true;
    }
    __device__ __forceinline__ void a_ready(const Unit&) const {}
    __device__ __forceinline__ void done(const Unit&) const {}
};

__device__ __forceinline__ unsigned cvt_pk_bf16(float lo, float hi) { unsigned r; asm volatile("v_cvt_pk_bf16_f32 %0, %1, %2" : "=v"(r) : "v"(lo), "v"(hi)); return r; }
__device__ __forceinline__ u32x4 pack8(const f32x4& v0, const f32x4& v1) { u32x4 w; w.x = cvt_pk_bf16(v0[0], v0[1]); w.y = cvt_pk_bf16(v0[2], v0[3]); w.z = cvt_pk_bf16(v1[0], v1[1]); w.w = cvt_pk_bf16(v1[2], v1[3]); return w; }
__device__ __forceinline__ float fast_sigmoid(float a) { return __builtin_amdgcn_rcpf(1.0f + __builtin_amdgcn_exp2f(-a * 1.4426950408889634f)); }

struct EpiBf16Plain {
    static constexpr bool PERM = true, AFTER_DRAIN = false;
    bf16_t* O; int ldc;
    __device__ __forceinline__ void operator()(const f32x4 (&acc)[2][2][4][2], const Unit& u, int wr, int wc, int fr, int fq) const {
        const int row0 = u.pm * BM + wr * 64 + fr, col0 = u.pn * BM + wc * 32 + 8 * fq;
#pragma unroll
        for (int ai = 0; ai < 2; ++ai)
#pragma unroll
            for (int m = 0; m < 4; ++m) { bf16_t* rowp = O + (size_t)(row0 + ai * HALF + m * 16) * ldc + col0;
#pragma unroll
                for (int bj = 0; bj < 2; ++bj) *(u32x4*)(rowp + bj * HALF) = pack8(acc[ai][bj][m][0], acc[ai][bj][m][1]); }
    }
};

struct EpiIn {
    static constexpr bool PERM = true, AFTER_DRAIN = false;
    bf16_t *Q, *K, *V, *U; float* out; float qscale;
    __device__ __forceinline__ void operator()(const f32x4 (&acc)[2][2][4][2], const Unit& u, int wr, int wc, int fr, int fq) const {
        const int pn = u.pn, cin = wc * 32 + 8 * fq;
#pragma unroll
        for (int ai = 0; ai < 2; ++ai)
#pragma unroll
            for (int m = 0; m < 4; ++m) {
                const int r = u.pm * BM + ai * HALF + wr * 64 + m * 16 + fr;
                if (pn < 2) {
#pragma unroll
                    for (int bj = 0; bj < 2; ++bj) *(u32x4*)(Q + (size_t)r * 512 + pn * 256 + bj * HALF + cin) = pack8(acc[ai][bj][m][0] * qscale, acc[ai][bj][m][1] * qscale);
                } else if (pn == 2) {
                    const int j = r - MP;
                    const int krow = (r < MP) ? r : (MP + (j >> 4) * SKEYS + NPAST + (j & 15));
                    *(u32x4*)(K + (size_t)krow * 128 + cin) = pack8(acc[ai][0][m][0], acc[ai][0][m][1]);
                    *(u32x4*)(V + (size_t)krow * 128 + cin) = pack8(acc[ai][1][m][0], acc[ai][1][m][1]);
                    float* kd = nullptr; float* vd = nullptr;
                    if (r < MP) { const int s = r & (SEQ - 1); if (s >= SEQ - 128) { const size_t idx = ((size_t)(r >> 11) * 128 + (s - (SEQ - 128))) * 128 + cin; kd = out + O_KP + idx; vd = out + O_VP + idx; } }
                    else { const size_t idx = (size_t)j * 128 + cin; kd = out + O_KS + idx; vd = out + O_VS + idx; }
                    if (kd) { *(f32x4*)kd = acc[ai][0][m][0]; *(f32x4*)(kd + 4) = acc[ai][0][m][1]; *(f32x4*)vd = acc[ai][1][m][0]; *(f32x4*)(vd + 4) = acc[ai][1][m][1]; }
                } else {
                    float* pd = nullptr;
                    if (r < MP) { const int s = r & (SEQ - 1); if (s >= SEQ - 15) pd = out + O_PP + ((size_t)(r >> 11) * 15 + (s - (SEQ - 15))) * 512; }
                    else { const int j = r - MP, l = j & 15; if (l >= 1) pd = out + O_PS + ((size_t)(j >> 4) * 15 + (l - 1)) * 512; }
#pragma unroll
                    for (int bj = 0; bj < 2; ++bj) { const int uc = (pn - 3) * 256 + bj * HALF + cin;
                        *(u32x4*)(U + (size_t)r * 512 + uc) = pack8(acc[ai][bj][m][0], acc[ai][bj][m][1]);
                        if (pd) { *(f32x4*)(pd + uc) = acc[ai][bj][m][0]; *(f32x4*)(pd + uc + 4) = acc[ai][bj][m][1]; } }
                }
            }
    }
};

struct EpiSwiGLU {
    static constexpr bool PERM = true, AFTER_DRAIN = false;
    bf16_t* O; int ldc;
    __device__ __forceinline__ void operator()(const f32x4 (&acc)[2][2][4][2], const Unit& u, int wr, int wc, int fr, int fq) const {
        const int row0 = u.pm * BM + wr * 64 + fr, col0 = u.pn * HALF + wc * 32 + 8 * fq;
#pragma unroll
        for (int ai = 0; ai < 2; ++ai)
#pragma unroll
            for (int m = 0; m < 4; ++m) { bf16_t* rowp = O + (size_t)(row0 + ai * HALF + m * 16) * ldc + col0;
                f32x4 a[2];
#pragma unroll
                for (int n = 0; n < 2; ++n) { const f32x4 g = acc[ai][0][m][n], up = acc[ai][1][m][n];
#pragma unroll
                    for (int e = 0; e < 4; ++e) a[n][e] = g[e] * fast_sigmoid(g[e]) * up[e]; }
                *(u32x4*)rowp = pack8(a[0], a[1]); }
    }
};

struct EpiPle {
    static constexpr bool PERM = false, AFTER_DRAIN = false;
    float* out; const bf16_t* pew;
    __device__ __forceinline__ void operator()(const f32x4 (&acc)[2][2][4][2], const Unit& u, int wr, int wc, int fr, int fq) const {
        const int row0 = u.pm * BM + wr * 64 + fr, col0 = u.pn * BM + wc * 32 + 4 * fq;
#pragma unroll
        for (int ai = 0; ai < 2; ++ai)
#pragma unroll
            for (int m = 0; m < 4; ++m) { const size_t off = (size_t)(row0 + ai * HALF + m * 16) * DM + col0;
#pragma unroll
                for (int bj = 0; bj < 2; ++bj)
#pragma unroll
                    for (int n = 0; n < 2; ++n) { const size_t o = off + bj * HALF + n * 16;
                        const f32x4 x2 = *(const f32x4*)(out + o); const unsigned long long pw = *(const unsigned long long*)(pew + o);
                        const f32x4 g = acc[ai][bj][m][n]; f32x4 r;
                        r[0] = x2[0] + fast_sigmoid(g[0]) * __uint_as_float((unsigned)(pw & 0xffffu) << 16);
                        r[1] = x2[1] + fast_sigmoid(g[1]) * __uint_as_float((unsigned)((pw >> 16) & 0xffffu) << 16);
                        r[2] = x2[2] + fast_sigmoid(g[2]) * __uint_as_float((unsigned)((pw >> 32) & 0xffffu) << 16);
                        r[3] = x2[3] + fast_sigmoid(g[3]) * __uint_as_float((unsigned)((pw >> 48) & 0xffffu) << 16);
                        *(f32x4*)(out + o) = r; } }
    }
};

template <class Epi, class Sched, bool ALIGN_EPI = false, bool SP2 = false>
__device__ __forceinline__ void gemm_phase(PG8_LAS unsigned char* lds, const Gemm g, const Sched& S, const Epi& E) {
    const int tid = threadIdx.x, wid = __builtin_amdgcn_readfirstlane(tid >> 6), lane = tid & 63, wr = wid >> 2, wc = wid & 3, fr = lane & 15, fq = lane >> 4;
    const int K = g.K, nt = K / BK;
    unsigned voffA[2], voffB[2];
#pragma unroll
    for (int i = 0; i < 2; ++i) { int R, C; stage_rc(tid * 16 + i * 8192, R, C); const int Rb = Epi::PERM ? ((R & ~31) + perm32(R & 31)) : R;
        voffA[i] = (unsigned)(R * K + C) * 2u; voffB[i] = (unsigned)(Rb * K + C) * 2u; }
    const size_t kstep = (size_t)(BK * 2);
    const size_t hstep = (size_t)HALF * K * 2;
    const size_t tstep = 2 * hstep;
    const unsigned ldsw = (unsigned)wid * 1024u;
    const int aoff = lds_byte(wr * 64 + fr, fq * 8), boff = lds_byte(wc * 32 + fr, fq * 8);
#define PG8_SA(b, h) (((b) * 2 + (h)) * HTB)
#define PG8_SB(b, h) ((4 + (b) * 2 + (h)) * HTB)
#define PG8_STAGE(bufoff, gbase, voff) do { _Pragma("unroll") for (int _i = 0; _i < 2; ++_i) \
        __builtin_amdgcn_global_load_lds((const unsigned*)((const char*)(gbase) + (voff)[_i]), (PG8_LAS unsigned*)(lds + (bufoff) + ldsw + _i * 8192), 16, 0, 0); } while (0)
#define PG8_LDA(dst, b, h) do { _Pragma("unroll") for (int m = 0; m < 4; ++m) _Pragma("unroll") for (int k = 0; k < 2; ++k) dst[m][k] = *(const PG8_LAS bf16x8*)(lds + PG8_SA(b, h) + aoff + m * 2048 + k * 1024); } while (0)
#define PG8_LDB(dst, b, h) do { _Pragma("unroll") for (int n = 0; n < 2; ++n) _Pragma("unroll") for (int k = 0; k < 2; ++k) dst[n][k] = *(const PG8_LAS bf16x8*)(lds + PG8_SB(b, h) + boff + n * 2048 + k * 1024); } while (0)
#define PG8_MMA(ai, bj, At, Bt) do { __builtin_amdgcn_s_setprio(1); _Pragma("unroll") for (int m = 0; m < 4; ++m) _Pragma("unroll") for (int n = 0; n < 2; ++n) _Pragma("unroll") for (int k = 0; k < 2; ++k) \
        acc[ai][bj][m][n] = __builtin_amdgcn_mfma_f32_16x16x32_bf16(Bt[n][k], At[m][k], acc[ai][bj][m][n], 0, 0, 0); __builtin_amdgcn_s_setprio(0); } while (0)
#define PG8_WAIT_V(n) asm volatile("s_waitcnt vmcnt(" #n ")" ::: "memory")
#define PG8_WAIT_L(n) asm volatile("s_waitcnt lgkmcnt(" #n ")" ::: "memory")
#define PG8_BAR __builtin_amdgcn_s_barrier()
#define PG8_SCHED __builtin_amdgcn_sched_barrier(0)
    Unit cur, nxt; int ui = 0;
    if (!S.next(0, cur)) return;
    f32x4 acc[2][2][4][2];
#pragma unroll
    for (int a = 0; a < 2; ++a)
#pragma unroll
        for (int b = 0; b < 2; ++b)
#pragma unroll
            for (int m = 0; m < 4; ++m)
#pragma unroll
                for (int n = 0; n < 2; ++n) acc[a][b][m][n] = (f32x4){0.f, 0.f, 0.f, 0.f};
    bf16x8 At[4][2], B0[2][2], B1[2][2];
    const char* cA = (const char*)g.A + (size_t)cur.pm * tstep; const char* cB = (const char*)g.Bt + (size_t)cur.pn * tstep;
    S.a_ready(cur);
    if constexpr (SP2) {
        PG8_STAGE(PG8_SB(0, 0), cB, voffB); PG8_STAGE(PG8_SB(0, 1), cB + hstep, voffB); PG8_STAGE(PG8_SA(0, 0), cA, voffA); PG8_STAGE(PG8_SA(0, 1), cA + hstep, voffA);
        if (wr == 1) PG8_BAR;
        PG8_WAIT_V(2); PG8_BAR;
        PG8_STAGE(PG8_SB(1, 0), cB + kstep, voffB); PG8_STAGE(PG8_SA(1, 0), cA + kstep, voffA); PG8_STAGE(PG8_SB(1, 1), cB + hstep + kstep, voffB);
        PG8_WAIT_V(6); PG8_BAR;
    } else {
        PG8_STAGE(PG8_SB(0, 0), cB, voffB); PG8_STAGE(PG8_SA(0, 0), cA, voffA); PG8_STAGE(PG8_SB(0, 1), cB + hstep, voffB); PG8_STAGE(PG8_SA(0, 1), cA + hstep, voffA);
        if (wr == 1) PG8_BAR;
        PG8_WAIT_V(4); PG8_BAR;
        PG8_STAGE(PG8_SB(1, 0), cB + kstep, voffB); PG8_STAGE(PG8_SA(1, 0), cA + kstep, voffA); PG8_STAGE(PG8_SB(1, 1), cB + hstep + kstep, voffB);
        PG8_WAIT_V(6); PG8_BAR;
    }
    for (;;) {
        const bool has_next = S.next(ui + 1, nxt);
        const char* nA = has_next ? (const char*)g.A + (size_t)nxt.pm * tstep : cA; const char* nB = has_next ? (const char*)g.Bt + (size_t)nxt.pn * tstep : cB;
        for (int t = 0; t < nt; t += 2) {
            const bool last = (t == nt - 2);
            const char* a1 = cA + (size_t)(t + 1) * kstep;
            const char* a2 = last ? nA : cA + (size_t)(t + 2) * kstep; const char* b2 = last ? nB : cB + (size_t)(t + 2) * kstep;
            const char* a3 = a2 + kstep; const char* b3 = b2 + kstep;
            if (last && has_next) S.a_ready(nxt);
            if constexpr (SP2) {
            PG8_LDB(B0, 0, 0); PG8_LDB(B1, 0, 1); PG8_SCHED; PG8_LDA(At, 0, 0); PG8_STAGE(PG8_SA(1, 1), a1 + hstep, voffA);
            PG8_WAIT_V(8); PG8_WAIT_L(0); PG8_BAR; PG8_MMA(0, 0, At, B0); PG8_MMA(0, 1, At, B1); PG8_BAR; PG8_SCHED;
            PG8_LDA(At, 0, 1); PG8_STAGE(PG8_SB(0, 0), b2, voffB); PG8_STAGE(PG8_SB(0, 1), b2 + hstep, voffB); PG8_STAGE(PG8_SA(0, 0), a2, voffA);
            PG8_WAIT_V(8); PG8_WAIT_L(0); PG8_BAR; PG8_MMA(1, 0, At, B0); PG8_MMA(1, 1, At, B1); PG8_BAR; PG8_SCHED;
            PG8_LDB(B0, 1, 0); PG8_LDB(B1, 1, 1); PG8_SCHED; PG8_LDA(At, 1, 0); PG8_STAGE(PG8_SA(0, 1), a2 + hstep, voffA);
            PG8_WAIT_V(8); PG8_WAIT_L(0); PG8_BAR; PG8_MMA(0, 0, At, B0); PG8_MMA(0, 1, At, B1); PG8_BAR; PG8_SCHED;
            PG8_LDA(At, 1, 1); PG8_STAGE(PG8_SB(1, 0), b3, voffB); PG8_STAGE(PG8_SB(1, 1), b3 + hstep, voffB); PG8_STAGE(PG8_SA(1, 0), a3, voffA);
            PG8_WAIT_V(8); PG8_WAIT_L(0); PG8_BAR; PG8_MMA(1, 0, At, B0); PG8_MMA(1, 1, At, B1); PG8_BAR; PG8_SCHED;
            } else {
            PG8_LDB(B0, 0, 0); PG8_SCHED; PG8_LDA(At, 0, 0); PG8_STAGE(PG8_SA(1, 1), a1 + hstep, voffA);
            PG8_WAIT_L(8); PG8_BAR; PG8_WAIT_L(0); PG8_MMA(0, 0, At, B0); PG8_BAR; PG8_SCHED;
            PG8_LDB(B1, 0, 1); PG8_STAGE(PG8_SB(0, 0), b2, voffB);
            PG8_BAR; PG8_WAIT_L(0); PG8_MMA(0, 1, At, B1); PG8_BAR;
            PG8_LDA(At, 0, 1); PG8_STAGE(PG8_SA(0, 0), a2, voffA);
            PG8_BAR; PG8_WAIT_L(0); PG8_MMA(1, 0, At, B0); PG8_BAR; PG8_SCHED;
            PG8_STAGE(PG8_SB(0, 1), b2 + hstep, voffB);
            PG8_WAIT_V(6); PG8_BAR; PG8_MMA(1, 1, At, B1); PG8_BAR;
            PG8_LDB(B0, 1, 0); PG8_SCHED; PG8_LDA(At, 1, 0); PG8_STAGE(PG8_SA(0, 1), a2 + hstep, voffA);
            PG8_WAIT_L(8); PG8_BAR; PG8_WAIT_L(0); PG8_MMA(0, 0, At, B0); PG8_BAR; PG8_SCHED;
            PG8_LDB(B1, 1, 1); PG8_STAGE(PG8_SB(1, 0), b3, voffB);
            PG8_BAR; PG8_WAIT_L(0); PG8_MMA(0, 1, At, B1); PG8_BAR;
            PG8_LDA(At, 1, 1); PG8_STAGE(PG8_SA(1, 0), a3, voffA);
            PG8_BAR; PG8_WAIT_L(0); PG8_MMA(1, 0, At, B0); PG8_BAR; PG8_SCHED;
            PG8_STAGE(PG8_SB(1, 1), b3 + hstep, voffB);
            PG8_WAIT_V(6); PG8_BAR; PG8_MMA(1, 1, At, B1); PG8_BAR;
            }
        }
        if constexpr (ALIGN_EPI) { if (wr == 0) PG8_BAR; }
        if constexpr (!Epi::AFTER_DRAIN) { E(acc, cur, wr, wc, fr, fq); S.done(cur); }
        if (!has_next) break;
#pragma unroll
        for (int a = 0; a < 2; ++a)
#pragma unroll
            for (int b = 0; b < 2; ++b)
#pragma unroll
                for (int m = 0; m < 4; ++m)
#pragma unroll
                    for (int n = 0; n < 2; ++n) acc[a][b][m][n] = (f32x4){0.f, 0.f, 0.f, 0.f};
        cur = nxt; cA = nA; cB = nB; ++ui;
        if constexpr (ALIGN_EPI) { if (wr == 1) PG8_BAR; }
    }
    PG8_WAIT_V(0);
    if constexpr (!ALIGN_EPI) { if (wr == 0) PG8_BAR; }
    PG8_BAR;
    if constexpr (Epi::AFTER_DRAIN) { E.fused(acc, cur, wr, wc, fr, fq, lds, wid, lane); S.done(cur); }
#undef PG8_SA
#undef PG8_SB
#undef PG8_STAGE
#undef PG8_LDA
#undef PG8_LDB
#undef PG8_MMA
#undef PG8_WAIT_V
#undef PG8_WAIT_L
#undef PG8_BAR
#undef PG8_SCHED
}
}
#define GAS __attribute__((address_space(1)))
#define LAS __attribute__((address_space(3)))
typedef unsigned short bf16;
typedef unsigned v4u __attribute__((ext_vector_type(4)));
typedef float f32x4 __attribute__((ext_vector_type(4)));
typedef float f32x16 __attribute__((ext_vector_type(16)));
typedef short bf16x8 __attribute__((ext_vector_type(8)));
typedef short s16x4 __attribute__((ext_vector_type(4)));
typedef GAS unsigned gu32;
typedef GAS unsigned long long gu64;
#define RLX_AGENT __ATOMIC_RELAXED, __HIP_MEMORY_SCOPE_AGENT
#define LDS_WAIT() asm volatile("s_waitcnt lgkmcnt(0)" ::: "memory")
#define VM_WAIT() asm volatile("s_waitcnt vmcnt(0)" ::: "memory")
__device__ __forceinline__ unsigned f2bf(float f) { unsigned u = __builtin_bit_cast(unsigned, f); return (u + 0x7fffu + ((u >> 16) & 1u)) >> 16; }
__device__ __forceinline__ unsigned pk2(float lo, float hi) { return f2bf(lo) | (f2bf(hi) << 16); }
__device__ __forceinline__ float bf_lo(unsigned w) { return __uint_as_float(w << 16); }
__device__ __forceinline__ float bf_hi(unsigned w) { return __uint_as_float(w & 0xffff0000u); }
__device__ __forceinline__ float wave_sum(float v) {
#pragma unroll
    for (int o = 1; o < 64; o <<= 1) v += __shfl_xor(v, o);
    return v;
}

constexpr int AT_K = 0, AT_V = 24576, AT_TAB = 49152, AT_WSF = 57344, AT_END = 59392;
__device__ __forceinline__ int crow(int r, int hi) { return (r & 3) + 8 * (r >> 2) + 4 * hi; }
__device__ __forceinline__ s16x4 vtr(const LAS unsigned char* p) { typedef short v4i16_t __attribute__((ext_vector_type(4))); return __builtin_bit_cast(s16x4, __builtin_amdgcn_ds_read_tr16_b64_v4i16((LAS v4i16_t*)p)); }

template <int MODE>
__device__ __forceinline__ void attn_unit(LAS unsigned char* lds, const bf16* Qb, const bf16* Kb, const bf16* Vb, bf16* Ob, const float* sinks, int qrow0, int krow0, int kvh, int j_lo, int j_hi, int tid, int wid, int lane) {
    constexpr int NB = MODE == 0 ? 6 : 5;
#pragma unroll
    for (int i = 0; i < 3; ++i) { const int p = tid + i * 512, row = p >> 3, c8 = p & 7;
        v4u kv = (v4u){0u, 0u, 0u, 0u}, vv = (v4u){0u, 0u, 0u, 0u};
        if (row >= j_lo && row < 32 * NB) { const size_t g = (size_t)(krow0 + row) * 128 + kvh * 64 + c8 * 8; kv = *(const v4u*)(Kb + g); vv = *(const v4u*)(Vb + g); }
        *(LAS v4u*)(lds + AT_K + c8 * 3072 + row * 16) = kv;
        *(LAS v4u*)(lds + AT_V + (c8 >> 2) * 12288 + (row >> 4) * 1024 + (row & 15) * 64 + (c8 & 3) * 16) = vv; }
    __syncthreads();
    if (MODE == 0 || wid < 2) {
        const int r32 = lane & 31, hi = lane >> 5;
        const int g = MODE == 0 ? (wid >> 1) : (2 * wid + (r32 >> 4)), qi = MODE == 0 ? (32 * (wid & 1) + r32) : (r32 & 15), h = kvh * 4 + g;
        const bf16* Qp = Qb + (size_t)(qrow0 + qi) * 512 + h * 64 + hi * 8;
        bf16x8 qr[4];
#pragma unroll
        for (int d0 = 0; d0 < 4; ++d0) qr[d0] = *(const bf16x8*)(Qp + d0 * 16);
        const float sink2 = sinks[h] * LOG2E;
        f32x16 p[NB];
#pragma unroll
        for (int b = 0; b < NB; ++b) { p[b] = f32x16{};
#pragma unroll
            for (int d0 = 0; d0 < 4; ++d0) { const bf16x8 kf = *(const LAS bf16x8*)(lds + AT_K + (2 * d0 + hi) * 3072 + (32 * b + r32) * 16);
                p[b] = __builtin_amdgcn_mfma_f32_32x32x16_bf16(kf, qr[d0], p[b], 0, 0, 0); } }
        const LAS float* tb = (const LAS float*)(lds + AT_TAB) + h * 256 + 63 - qi + 4 * hi;
        float mx = sink2;
#pragma unroll
        for (int b = 0; b < NB; ++b)
#pragma unroll
            for (int r = 0; r < 16; ++r) { const int jo = 32 * b + (r & 3) + 8 * (r >> 2), j = jo + 4 * hi;
                float s = p[b][r] + tb[jo];
                s = (j >= j_lo && j < j_hi) ? s : -INFINITY;
                p[b][r] = s; mx = fmaxf(mx, s); }
        mx = fmaxf(mx, __shfl_xor(mx, 32));
        float ls = 0.f;
#pragma unroll
        for (int b = 0; b < NB; ++b)
#pragma unroll
            for (int r = 0; r < 16; ++r) { const float e = __builtin_amdgcn_exp2f(p[b][r] - mx); p[b][r] = e; ls += e; }
        ls += __shfl_xor(ls, 32);
        ls += __builtin_amdgcn_exp2f(sink2 - mx);
        f32x16 o[2]; o[0] = f32x16{}; o[1] = f32x16{};
        const LAS unsigned char* vp0 = lds + AT_V + ((lane >> 4) & 1) * 32 + (lane & 3) * 8 + (4 * hi + ((lane & 15) >> 2)) * 64;
#pragma unroll
        for (int b = 0; b < NB; ++b)
#pragma unroll
            for (int s = 0; s < 2; ++s) {
                v4u pw; pw.x = pk2(p[b][8 * s + 0], p[b][8 * s + 1]); pw.y = pk2(p[b][8 * s + 2], p[b][8 * s + 3]); pw.z = pk2(p[b][8 * s + 4], p[b][8 * s + 5]); pw.w = pk2(p[b][8 * s + 6], p[b][8 * s + 7]);
                const bf16x8 pa = __builtin_bit_cast(bf16x8, pw);
#pragma unroll
                for (int d0 = 0; d0 < 2; ++d0) { const LAS unsigned char* vp = vp0 + d0 * 12288 + (2 * b + s) * 1024;
                    const s16x4 lo = vtr(vp), hh = vtr(vp + 512);
                    const bf16x8 vf = (bf16x8){lo[0], lo[1], lo[2], lo[3], hh[0], hh[1], hh[2], hh[3]};
                    o[d0] = __builtin_amdgcn_mfma_f32_32x32x16_bf16(pa, vf, o[d0], 0, 0, 0); } }
        LAS float* wsf = (LAS float*)(lds + AT_WSF) + wid * 64;
        if (hi == 0) wsf[r32] = ls;
        LDS_WAIT();
#pragma unroll
        for (int r = 0; r < 16; ++r) { const int q32 = crow(r, hi); const float li = __builtin_amdgcn_rcpf(wsf[q32]);
            const int orow = MODE == 0 ? (qrow0 + 32 * (wid & 1) + q32) : (qrow0 + (q32 & 15));
            const int oh = MODE == 0 ? h : (kvh * 4 + 2 * wid + (r >> 3));
            bf16* op = Ob + (size_t)orow * DM + oh * 64 + r32;
            op[0] = (bf16)f2bf(o[0][r] * li); op[32] = (bf16)f2bf(o[1][r] * li); }
    }
    __syncthreads();
}

__device__ __forceinline__ void pool_row(const bf16* U, const float* state_pool, bf16* MIX, int r, int lane) {
    const int ch0 = lane * 8, w = 2 << (lane >> 4);
    float acc[8], cur[8];
#pragma unroll
    for (int e = 0; e < 8; ++e) acc[e] = 0.f;
    int cnt = w;
    if (r < MP) {
        const int s = r & (SEQ - 1); cnt = (s + 1 < w) ? (s + 1) : w;
        for (int j = 0; j < 16; ++j) { if (j < cnt) { const v4u x = *(const v4u*)(U + (size_t)(r - j) * 512 + ch0);
                const float v[8] = {bf_lo(x.x), bf_hi(x.x), bf_lo(x.y), bf_hi(x.y), bf_lo(x.z), bf_hi(x.z), bf_lo(x.w), bf_hi(x.w)};
#pragma unroll
                for (int e = 0; e < 8; ++e) { acc[e] += v[e]; if (j == 0) cur[e] = v[e]; } } }
    } else {
        const int jj = r - MP, b = jj >> 4, l = jj & 15;
        for (int j = 0; j < 16; ++j) { if (j < w) {
                if (l - j >= 0) { const v4u x = *(const v4u*)(U + (size_t)(r - j) * 512 + ch0);
                    const float v[8] = {bf_lo(x.x), bf_hi(x.x), bf_lo(x.y), bf_hi(x.y), bf_lo(x.z), bf_hi(x.z), bf_lo(x.w), bf_hi(x.w)};
#pragma unroll
                    for (int e = 0; e < 8; ++e) { acc[e] += v[e]; if (j == 0) cur[e] = v[e]; } }
                else { const float* sp = state_pool + ((size_t)b * 15 + (15 + l - j)) * 512 + ch0; const f32x4 a = *(const f32x4*)sp, c = *(const f32x4*)(sp + 4);
                    acc[0] += a[0]; acc[1] += a[1]; acc[2] += a[2]; acc[3] += a[3]; acc[4] += c[0]; acc[5] += c[1]; acc[6] += c[2]; acc[7] += c[3]; } } }
    }
    const float inv = 1.0f / (float)cnt;
    v4u o; o.x = pk2(acc[0] * inv - cur[0], acc[1] * inv - cur[1]); o.y = pk2(acc[2] * inv - cur[2], acc[3] * inv - cur[3]);
    o.z = pk2(acc[4] * inv - cur[4], acc[5] * inv - cur[5]); o.w = pk2(acc[6] * inv - cur[6], acc[7] * inv - cur[7]);
    *(v4u*)(MIX + (size_t)r * DM + 512 + ch0) = o;
}

constexpr int NWAVES = 8;
#ifndef MK_N_LAUNCHES
#define MK_N_LAUNCHES 1
#endif
constexpr int N_LAUNCHES = MK_N_LAUNCHES;
constexpr int NPHASE = 9;
constexpr size_t MiB = 1u << 20;
constexpr size_t WS_CTL = 0, CTL_ZERO_BYTES = 64 * 1024;
constexpr size_t WS_BIAS = 1 * MiB;
constexpr size_t WS_WIN = 2 * MiB, WS_WCOMB = 5 * MiB, WS_WGU = 7 * MiB, WS_WD = 18 * MiB, WS_WPG = 24 * MiB, WS_WPLE = 26 * MiB;
constexpr size_t WS_H = 27 * MiB;
constexpr size_t WS_PEW = 60 * MiB;
constexpr size_t WS_MIXIN = 93 * MiB;
constexpr size_t WS_ACT = 126 * MiB;
constexpr size_t WS_PEB = 126 * MiB, WS_Q = 135 * MiB, WS_K = 152 * MiB, WS_V = 158 * MiB, WS_U = 164 * MiB;
constexpr size_t WS_MIXF = 184 * MiB;
constexpr size_t WS_END = 220 * MiB;
static_assert(WS_ACT + (size_t)M * DFF * 2 <= WS_END && WS_MIXF + (size_t)M * DM * 2 <= WS_END && WS_U + (size_t)M * 512 * 2 <= WS_MIXF && WS_K + (size_t)KROWS * 256 <= WS_V && WS_V + (size_t)KROWS * 256 <= WS_U, "d_ws map");
static_assert(WS_H + (size_t)M * DM * 2 <= WS_PEW && WS_PEW + (size_t)M * DM * 2 <= WS_MIXIN && WS_MIXIN + (size_t)M * DM * 2 <= WS_ACT && WS_PEB + (size_t)M * PLE * 2 <= WS_Q && WS_Q + (size_t)M * 512 * 2 <= WS_K, "d_ws map");
constexpr int CW_BAR = 4096;
constexpr int RING_OFF = 0, RING_BYTES = 131072;
constexpr int LDSCTL_OFF = RING_BYTES, MISC_OFF = LDSCTL_OFF + 320;
constexpr int LDS_BYTES = 147456;
static_assert(MISC_OFF + 128 <= LDS_BYTES && AT_END <= RING_BYTES, "LDS map");

#define XB_TMO      128
#define XB_XCNT(j)  (256  + 64 * (j))
#define XB_XSUB(j)  (1280 + 64 * (j))
#define XB_XGEN(j)  (2304 + 64 * (j))
#define XB_TOP      3328
#define XB_TOPGEN   3392
#define XCD_BAR_WORDS 3456
#define XB_SPIN_CAP (1u << 18)
__device__ __forceinline__ unsigned xb_ld(unsigned* p)              { return __hip_atomic_load(p, __ATOMIC_RELAXED, __HIP_MEMORY_SCOPE_AGENT); }
__device__ __forceinline__ unsigned xb_add(unsigned* p, unsigned v) { return __hip_atomic_fetch_add(p, v, __ATOMIC_RELAXED, __HIP_MEMORY_SCOPE_AGENT); }
__device__ __forceinline__ unsigned xb_xcc_id() { return (unsigned)__builtin_amdgcn_s_getreg((3 << 11) | 20) & 0xFu; }
#define XB_SPIN(cond, bar) do { unsigned _sp = 0; while (cond) { __builtin_amdgcn_s_sleep(1); \
    if ((++_sp & 255u) == 0u) { if (xb_ld(&(bar)[XB_TMO])) break; if (_sp > XB_SPIN_CAP) { atomicAdd(&(bar)[XB_TMO], 1u); break; } } } } while (0)
struct XcdBarrier { unsigned* bar; unsigned x; volatile LAS unsigned* st; };
__device__ __forceinline__ XcdBarrier xcd_barrier_post(unsigned* bar, volatile LAS unsigned* st) {
    XcdBarrier b; b.bar = bar; b.x = xb_xcc_id(); b.st = st;
    if (threadIdx.x == 0) (void)xb_add(&bar[XB_XCNT(b.x)], 1u);
    return b;
}
__device__ __forceinline__ void xcd_barrier_complete(unsigned* bar, unsigned x, unsigned& nloc, unsigned& nx) {
    const unsigned G = gridDim.x * gridDim.y * gridDim.z;
    unsigned sum, cnt, mine, sp = 0u;
    for (;;) {
        sum = 0u; cnt = 0u; mine = 0u;
#pragma unroll
        for (unsigned j = 0; j < 16; ++j) { const unsigned c = xb_ld(&bar[XB_XCNT(j)]); sum += c; cnt += (c > 0u) ? 1u : 0u; mine = (j == x) ? c : mine; }
        if (sum == G) break;
        __builtin_amdgcn_s_sleep(1);
        if ((++sp & 255u) == 0u) { if (xb_ld(&bar[XB_TMO])) break; if (sp > XB_SPIN_CAP) { atomicAdd(&bar[XB_TMO], 1u); break; } }
    }
    nloc = mine > 0u ? mine : 1u; nx = cnt > 0u ? cnt : 1u;
}
__device__ __forceinline__ void xcd_barrier(const XcdBarrier& b) {
    asm volatile("s_waitcnt vmcnt(0)" ::: "memory");
    __syncthreads();
    if (threadIdx.x == 0) {
        unsigned* bar = b.bar;
        __builtin_amdgcn_s_waitcnt(0);
        unsigned nloc = b.st[0], nx = b.st[1];
        if (nloc == 0u) { xcd_barrier_complete(bar, b.x, nloc, nx); b.st[0] = nloc; b.st[1] = nx; }
        const unsigned old = xb_add(&bar[XB_XSUB(b.x)], 1u);
        const unsigned gen = old / nloc;
        if (old + 1u == (gen + 1u) * nloc) {
            __builtin_amdgcn_fence(__ATOMIC_RELEASE, "agent");
            asm volatile("s_waitcnt vmcnt(0)" ::: "memory");
            const unsigned og = xb_add(&bar[XB_TOP], 1u);
            const unsigned tg = og / nx;
            if (og + 1u == (tg + 1u) * nx) xb_add(&bar[XB_TOPGEN], 1u);
            else XB_SPIN(xb_ld(&bar[XB_TOPGEN]) == tg, bar);
            __builtin_amdgcn_fence(__ATOMIC_ACQUIRE, "agent");
            xb_add(&bar[XB_XGEN(b.x)], 1u);
            asm volatile("s_waitcnt vmcnt(0)" ::: "memory");
        } else {
            XB_SPIN(xb_ld(&bar[XB_XGEN(b.x)]) == gen, bar);
            __builtin_amdgcn_fence(__ATOMIC_ACQUIRE, "agent");
            asm volatile("s_waitcnt vmcnt(0)" ::: "memory");
        }
    }
    __syncthreads();
}

__device__ __forceinline__ void tr_item(const float* W, int N, int k0, int n0, bf16* WT, int orow0, int ldo, int kout0, LAS float* scr, int lane) {
#pragma unroll 8
    for (int i = 0; i < 32; ++i) { const int kk = 2 * i + (lane >> 5); scr[kk * 33 + (lane & 31)] = W[(size_t)(k0 + kk) * N + n0 + (lane & 31)]; }
    LDS_WAIT(); asm volatile("" ::: "memory");
    const int c = lane & 7;
#pragma unroll
    for (int j = 0; j < 4; ++j) { const int n = (lane >> 3) + 8 * j; const LAS float* s = scr + (8 * c) * 33 + n;
        v4u o; o.x = pk2(s[0 * 33], s[1 * 33]); o.y = pk2(s[2 * 33], s[3 * 33]); o.z = pk2(s[4 * 33], s[5 * 33]); o.w = pk2(s[6 * 33], s[7 * 33]);
        *(GAS v4u*)(WT + (size_t)(orow0 + n) * ldo + kout0 + 8 * c) = o; }
    LDS_WAIT(); asm volatile("" ::: "memory");
}
__device__ __forceinline__ void tr_plain(const float* W, int K, int N, bf16* WT, LAS float* scr, int item, int lane) {
    const int nblk = N / 32, kb = item / nblk, nb = item % nblk; tr_item(W, N, 64 * kb, 32 * nb, WT, 32 * nb, K, 64 * kb, scr, lane);
}
__device__ __forceinline__ void rms_row_to_bf16(const float* xrow, const float* g, bf16* orow, int lane) {
    const GAS f32x4* xr = (const GAS f32x4*)xrow + lane; const GAS f32x4* gr = (const GAS f32x4*)g + lane;
    f32x4 v[4]; float s = 0.f;
#pragma unroll
    for (int j = 0; j < 4; ++j) { v[j] = xr[64 * j]; s += (v[j].x * v[j].x + v[j].y * v[j].y) + (v[j].z * v[j].z + v[j].w * v[j].w); }
    const float rstd = 1.f / sqrtf(wave_sum(s) * (1.f / DM) + RMS_EPS);
    GAS unsigned long long* o8 = (GAS unsigned long long*)orow + lane;
#pragma unroll
    for (int j = 0; j < 4; ++j) { const f32x4 gg = gr[64 * j];
        o8[64 * j] = (unsigned long long)pk2(v[j].x * rstd * gg.x, v[j].y * rstd * gg.y) | ((unsigned long long)pk2(v[j].z * rstd * gg.z, v[j].w * rstd * gg.w) << 32); }
}
__device__ __forceinline__ int t5_bucket(int rel) {
    const int n = rel < 0 ? -rel : rel; int b = rel > 0 ? 16 : 0;
    if (n < 8) return b + n;
    int large = 2 + (31 - __builtin_clz((unsigned)(n * n))); if (large > 15) large = 15;
    return b + large;
}

struct Ptrs {
    const float *x_prompt, *x_sample, *cache_k, *cache_v, *state_pool, *p_prompt, *p_sample, *rel_bias, *g_mix_pre, *w_in, *sinks, *w_pool, *pool_scale, *w_out, *g_mix_post, *g_ffn_pre,
                *w_gate, *w_up, *w_down, *g_ffn_post, *w_ple, *w_ple_gate;
    float* out; unsigned char* ws;
};

__device__ __forceinline__ void p0_prologue(const Ptrs& P, LAS unsigned char* lds, int vcu, int G, int wave, int lane, int tid) {
    LAS float* scr = (LAS float*)(lds + RING_OFF + wave * 16384);
    const int gw = vcu * NWAVES + wave, NGW = G * NWAVES;
    unsigned char* ws = P.ws;
    bf16 *Win_t = (bf16*)(ws + WS_WIN), *Wcomb_t = (bf16*)(ws + WS_WCOMB), *Wgu_t = (bf16*)(ws + WS_WGU), *Wd_t = (bf16*)(ws + WS_WD), *Wpg_t = (bf16*)(ws + WS_WPG), *Wple_t = (bf16*)(ws + WS_WPLE);
    constexpr int I_IN = (DM / 64) * (NIN / 32), I_OT = (512 / 64) * (DM / 32), I_G = (DM / 64) * (DFF / 32), I_D = (DFF / 64) * (DM / 32), I_PG = (DM / 64) * (DM / 32), I_PL = (PLE / 64) * (DM / 32), I_WP = 64 * 16;
    constexpr int NITEMS = I_IN + I_OT + 2 * I_G + I_D + I_PG + I_PL + I_WP;
    for (int it = gw; it < NITEMS; it += NGW) {
        int r = it;
        if (r < I_IN) { tr_plain(P.w_in, DM, NIN, Win_t, scr, r, lane); continue; } r -= I_IN;
        if (r < I_OT) { tr_plain(P.w_out, DM  , DM, Wcomb_t, scr, r, lane); continue; } r -= I_OT;
        if (r < 2 * I_G) { const int up = r >= I_G; if (up) r -= I_G; const int nblk = DFF / 32, kb = r / nblk, nb = r % nblk, n0 = 32 * nb;
            tr_item(up ? P.w_up : P.w_gate, DFF, 64 * kb, n0, Wgu_t, 256 * (n0 >> 7) + (n0 & 127) + (up ? 128 : 0), DM, 64 * kb, scr, lane); continue; } r -= 2 * I_G;
        if (r < I_D) { tr_plain(P.w_down, DFF, DM, Wd_t, scr, r, lane); continue; } r -= I_D;
        if (r < I_PG) { tr_plain(P.w_ple_gate, DM, DM, Wpg_t, scr, r, lane); continue; } r -= I_PG;
        if (r < I_PL) { tr_plain(P.w_ple, PLE, DM, Wple_t, scr, r, lane); continue; } r -= I_PL;
        {
            const int cb = r >> 4, nb = r & 15, c0 = 8 * cb, g = c0 >> 7, n = 64 * nb + lane;
            const float* wp = P.w_pool + ((size_t)g * 128 + (c0 & 127)) * 128; const float* sc = P.pool_scale + g * 128; const float* wo = P.w_out + (size_t)(512 + g * 128) * DM + n;
            float a[8];
#pragma unroll
            for (int i = 0; i < 8; ++i) a[i] = 0.f;
#pragma unroll 4
            for (int e = 0; e < 128; ++e) { const float wv = wo[(size_t)e * DM] * sc[e];
#pragma unroll
                for (int i = 0; i < 8; ++i) a[i] += wp[i * 128 + e] * wv; }
            v4u o; o.x = pk2(a[0], a[1]); o.y = pk2(a[2], a[3]); o.z = pk2(a[4], a[5]); o.w = pk2(a[6], a[7]);
            *(GAS v4u*)(Wcomb_t + (size_t)n * DM + 512 + c0) = o;
        }
    }
    bf16* H = (bf16*)(ws + WS_H);
    for (int m = gw; m < M; m += NGW) rms_row_to_bf16(m < MP ? P.x_prompt + (size_t)m * DM : P.x_sample + (size_t)(m - MP) * DM, P.g_mix_pre, H + (size_t)m * DM, lane);
    { bf16* PEB = (bf16*)(ws + WS_PEB); const int NG8 = M * PLE / 8, NGP = MP * PLE / 8;
      for (int i = gw * 64 + lane; i < NG8; i += NGW * 64) { const float* src = i < NGP ? P.p_prompt + (size_t)i * 8 : P.p_sample + (size_t)(i - NGP) * 8;
          const f32x4 a = *(const f32x4*)src, b = *(const f32x4*)(src + 4); v4u o; o.x = pk2(a[0], a[1]); o.y = pk2(a[2], a[3]); o.z = pk2(b[0], b[1]); o.w = pk2(b[2], b[3]); *(v4u*)(PEB + (size_t)i * 8) = o; } }
    { bf16* Kb = (bf16*)(ws + WS_K); bf16* Vb = (bf16*)(ws + WS_V); const int NG8 = NB_S * NPAST * 128 / 8;
      for (int i = gw * 64 + lane; i < NG8; i += NGW * 64) { const int b = i >> 11, rem = i & 2047, j = rem >> 4, c8 = rem & 15; const size_t dst = (size_t)(MP + b * SKEYS + j) * 128 + c8 * 8;
          { const float* src = P.cache_k + (size_t)i * 8; const f32x4 a = *(const f32x4*)src, c = *(const f32x4*)(src + 4); v4u o; o.x = pk2(a[0], a[1]); o.y = pk2(a[2], a[3]); o.z = pk2(c[0], c[1]); o.w = pk2(c[2], c[3]); *(v4u*)(Kb + dst) = o; }
          { const float* src = P.cache_v + (size_t)i * 8; const f32x4 a = *(const f32x4*)src, c = *(const f32x4*)(src + 4); v4u o; o.x = pk2(a[0], a[1]); o.y = pk2(a[2], a[3]); o.z = pk2(c[0], c[1]); o.w = pk2(c[2], c[3]); *(v4u*)(Vb + dst) = o; } }
      for (int i = gw * 64 + lane; i < 64 * 128 / 8; i += NGW * 64) { const size_t dst = (size_t)(MP + NB_S * SKEYS) * 128 + (size_t)i * 8; *(v4u*)(Kb + dst) = (v4u){0u, 0u, 0u, 0u}; *(v4u*)(Vb + dst) = (v4u){0u, 0u, 0u, 0u}; } }
    if (vcu == 0) { float* tab = (float*)(ws + WS_BIAS);
        for (int i = tid; i < 8 * 256; i += NWAVES * 64) { const int h = i >> 8, idx = i & 255; tab[i] = idx < 255 ? P.rel_bias[t5_bucket(idx - 191) * 8 + h] * LOG2E : 0.f; } }
}

__device__ __forceinline__ void norm_row_a(const float* xrow, const bf16* mrow, const float* g1, const float* g2, float* orow, bf16* hrow, int lane) {
    const GAS f32x4* xr = (const GAS f32x4*)xrow + lane; const GAS unsigned long long* mr = (const GAS unsigned long long*)mrow + lane;
    f32x4 v[4], mx[4]; float s = 0.f;
#pragma unroll
    for (int j = 0; j < 4; ++j) { const unsigned long long w = mr[64 * j]; const unsigned lo = (unsigned)w, hi = (unsigned)(w >> 32); mx[j] = (f32x4){bf_lo(lo), bf_hi(lo), bf_lo(hi), bf_hi(hi)}; v[j] = xr[64 * j];
        s += (mx[j].x * mx[j].x + mx[j].y * mx[j].y) + (mx[j].z * mx[j].z + mx[j].w * mx[j].w); }
    const float rstd1 = 1.f / sqrtf(wave_sum(s) * (1.f / DM) + RMS_EPS); float s2 = 0.f;
#pragma unroll
    for (int j = 0; j < 4; ++j) { const f32x4 gg = ((const GAS f32x4*)g1 + lane)[64 * j]; v[j] = v[j] + mx[j] * rstd1 * gg; s2 += (v[j].x * v[j].x + v[j].y * v[j].y) + (v[j].z * v[j].z + v[j].w * v[j].w); }
    const float rstd2 = 1.f / sqrtf(wave_sum(s2) * (1.f / DM) + RMS_EPS);
    GAS f32x4* orp = (GAS f32x4*)orow + lane; GAS unsigned long long* o8 = (GAS unsigned long long*)hrow + lane;
#pragma unroll
    for (int j = 0; j < 4; ++j) { orp[64 * j] = v[j]; const f32x4 gg = ((const GAS f32x4*)g2 + lane)[64 * j];
        o8[64 * j] = (unsigned long long)pk2(v[j].x * rstd2 * gg.x, v[j].y * rstd2 * gg.y) | ((unsigned long long)pk2(v[j].z * rstd2 * gg.z, v[j].w * rstd2 * gg.w) << 32); }
}
__device__ __forceinline__ void norm_row_b(const bf16* frow, const float* g, float* orow, bf16* brow, int lane) {
    GAS f32x4* orp = (GAS f32x4*)orow + lane; const GAS unsigned long long* mr = (const GAS unsigned long long*)frow + lane;
    f32x4 v[4], mx[4]; float s = 0.f;
#pragma unroll
    for (int j = 0; j < 4; ++j) { const unsigned long long w = mr[64 * j]; const unsigned lo = (unsigned)w, hi = (unsigned)(w >> 32); mx[j] = (f32x4){bf_lo(lo), bf_hi(lo), bf_lo(hi), bf_hi(hi)}; v[j] = orp[64 * j];
        s += (mx[j].x * mx[j].x + mx[j].y * mx[j].y) + (mx[j].z * mx[j].z + mx[j].w * mx[j].w); }
    const float rstd = 1.f / sqrtf(wave_sum(s) * (1.f / DM) + RMS_EPS);
    GAS unsigned long long* o8 = (GAS unsigned long long*)brow + lane;
#pragma unroll
    for (int j = 0; j < 4; ++j) { const f32x4 gg = ((const GAS f32x4*)g + lane)[64 * j]; v[j] = v[j] + mx[j] * rstd * gg; orp[64 * j] = v[j];
        o8[64 * j] = (unsigned long long)pk2(v[j].x, v[j].y) | ((unsigned long long)pk2(v[j].z, v[j].w) << 32); }
}

struct Args { Ptrs p; int ph_lo, ph_hi, li, pad; };
#ifndef PG8_SP2
#define PG8_SP2 true
#endif
#ifndef PG8_ALIGN
#define PG8_ALIGN true
#endif
__global__ void __launch_bounds__(NWAVES * 64, 2) mk_fwd(Args args) {
    extern __shared__ __attribute__((aligned(16))) unsigned char lds_raw[];
    LAS unsigned char* lds = (LAS unsigned char*)lds_raw;
    volatile LAS unsigned* MISC = (volatile LAS unsigned*)(lds + MISC_OFF);
    const int tid = threadIdx.x, lane = tid & 63, wave = __builtin_amdgcn_readfirstlane(tid >> 6);
    const int G = gridDim.x; const int bx = blockIdx.x; const int vcu = (G % 8 == 0) ? (bx % 8) * (G / 8) + bx / 8 : bx;
    const Ptrs& P = args.p;
    unsigned char* ws = P.ws;
    gu32* ctl = (gu32*)(ws + WS_CTL);
    for (int u = tid; u < (LDS_BYTES - LDSCTL_OFF) / 4; u += NWAVES * 64) ((LAS unsigned*)(lds + LDSCTL_OFF))[u] = 0u;
    __syncthreads();
    XcdBarrier bar; bar.bar = (unsigned*)(ctl + CW_BAR); bar.x = 0; bar.st = nullptr;
    if (N_LAUNCHES != NPHASE) bar = xcd_barrier_post((unsigned*)(ctl + CW_BAR), MISC + 8);
#define GRID_BAR() do { if (N_LAUNCHES != NPHASE) xcd_barrier(bar); } while (0)
    const int lo = args.ph_lo, hi = args.ph_hi;
#define IN(k) (lo <= (k) && (k) < hi)
#define BOTH(k) (IN(k) && IN((k) + 1))
    bf16 *Win_t = (bf16*)(ws + WS_WIN), *Wcomb_t = (bf16*)(ws + WS_WCOMB), *Wgu_t = (bf16*)(ws + WS_WGU), *Wd_t = (bf16*)(ws + WS_WD), *Wpg_t = (bf16*)(ws + WS_WPG), *Wple_t = (bf16*)(ws + WS_WPLE);
    bf16 *H = (bf16*)(ws + WS_H), *PEW = (bf16*)(ws + WS_PEW), *MIXIN = (bf16*)(ws + WS_MIXIN), *ACT = (bf16*)(ws + WS_ACT), *PEB = (bf16*)(ws + WS_PEB), *Qb = (bf16*)(ws + WS_Q), *Kb = (bf16*)(ws + WS_K), *Vb = (bf16*)(ws + WS_V),
         *Ub = (bf16*)(ws + WS_U), *MIXF = (bf16*)(ws + WS_MIXF);
    const int gw = vcu * NWAVES + wave, NGW = G * NWAVES;

    if (IN(0)) { p0_prologue(P, lds, vcu, G, wave, lane, tid); if (BOTH(0)) GRID_BAR(); }

    if (IN(1)) {
        { pg8::Gemm g{H, Win_t, M, NIN, DM}; pg8::StaticOrder S; S.init(M, NIN, G, bx);
          pg8::EpiIn E{Qb, Kb, Vb, Ub, P.out, QSCALE};
          pg8::gemm_phase<pg8::EpiIn, pg8::StaticOrder, PG8_ALIGN, PG8_SP2>(lds + RING_OFF, g, S, E); }
        { pg8::Gemm g{PEB, Wple_t, M, DM, PLE}; pg8::StaticOrder S; S.init(M, DM, G, (bx + 128) % G);
          pg8::EpiBf16Plain E{PEW, DM};
          pg8::gemm_phase<pg8::EpiBf16Plain, pg8::StaticOrder, PG8_ALIGN, PG8_SP2>(lds + RING_OFF, g, S, E); }
        if (BOTH(1)) GRID_BAR();
    }

    if (IN(2)) {
        { const float* tab = (const float*)(ws + WS_BIAS); for (int i = tid; i < 8 * 256; i += NWAVES * 64) ((LAS float*)(lds + AT_TAB))[i] = tab[i]; }
        for (int base = vcu * 2; base < 512; base += 2 * G)
            for (int i = 0; i < 2; ++i) { const int iu = base + i; const int c = iu & 31, bk = iu >> 5, kvh = bk & 1, b = bk >> 1;
                attn_unit<0>(lds, Qb, Kb, Vb, MIXIN, P.sinks, b * SEQ + c * 64, b * SEQ + c * 64 - 128, kvh, c >= 2 ? 0 : 128 - 64 * c, 192, tid, wave, lane); }
        for (int su = vcu; su < 64; su += G) { const int b = su >> 1, kvh = su & 1; attn_unit<1>(lds, Qb, Kb, Vb, MIXIN, P.sinks, MP + b * LS, MP + b * SKEYS, kvh, 0, SKEYS, tid, wave, lane); }
        for (int r = gw; r < M; r += NGW) pool_row(Ub, P.state_pool, MIXIN, r, lane);
        if (BOTH(2)) GRID_BAR();
    }

    if (IN(3)) {
        pg8::Gemm g{MIXIN, Wcomb_t, M, DM, DM}; pg8::StaticOrder S; S.init(M, DM, G, bx);
        pg8::EpiBf16Plain E{MIXF, DM};
        pg8::gemm_phase<pg8::EpiBf16Plain, pg8::StaticOrder, PG8_ALIGN, PG8_SP2>(lds + RING_OFF, g, S, E);
        if (BOTH(3)) GRID_BAR();
    }
    if (IN(4)) {
        for (int m = gw; m < M; m += NGW) norm_row_a(m < MP ? P.x_prompt + (size_t)m * DM : P.x_sample + (size_t)(m - MP) * DM, MIXF + (size_t)m * DM, P.g_mix_post, P.g_ffn_pre, P.out + (size_t)m * DM, H + (size_t)m * DM, lane);
        if (BOTH(4)) GRID_BAR();
    }
    if (IN(5)) {
        pg8::Gemm g{H, Wgu_t, M, NGU, DM}; pg8::StaticOrder S; S.init(M, NGU, G, bx);
        pg8::EpiSwiGLU E{ACT, DFF};
        pg8::gemm_phase<pg8::EpiSwiGLU, pg8::StaticOrder, PG8_ALIGN, PG8_SP2>(lds + RING_OFF, g, S, E);
        if (BOTH(5)) GRID_BAR();
    }
    if (IN(6)) {
        pg8::Gemm g{ACT, Wd_t, M, DM, DFF}; pg8::StaticOrder S; S.init(M, DM, G, bx);
        pg8::EpiBf16Plain E{H, DM};
        pg8::gemm_phase<pg8::EpiBf16Plain, pg8::StaticOrder, PG8_ALIGN, PG8_SP2>(lds + RING_OFF, g, S, E);
        if (BOTH(6)) GRID_BAR();
    }
    if (IN(7)) {
        for (int m = gw; m < M; m += NGW) norm_row_b(H + (size_t)m * DM, P.g_ffn_post, P.out + (size_t)m * DM, MIXIN + (size_t)m * DM, lane);
        if (BOTH(7)) GRID_BAR();
    }
    if (IN(8)) {
        pg8::Gemm g{MIXIN, Wpg_t, M, DM, DM}; pg8::StaticOrder S; S.init(M, DM, G, bx);
        pg8::EpiPle E{P.out, PEW};
        pg8::gemm_phase<pg8::EpiPle, pg8::StaticOrder, PG8_ALIGN, PG8_SP2>(lds + RING_OFF, g, S, E);
    }
#undef IN
#undef BOTH
}

extern "C" void kernel_launch(void* const* d_in, const int* in_sizes, int n_in, void* d_out, int out_size, void* d_ws, size_t ws_size, hipStream_t stream) {
    static int grid = 0;
    if (grid == 0) {
        if (n_in != 22 || ws_size < WS_END) { fprintf(stderr, "kernel_launch: unexpected inputs (n_in %d, ws %zu)\n", n_in, ws_size); grid = -1; return; }
        int dev = 0, cus = 0, per_cu = 0;
        if (hipGetDevice(&dev) != hipSuccess || hipDeviceGetAttribute(&cus, hipDeviceAttributeMultiprocessorCount, dev) != hipSuccess) { grid = -1; return; }
        if (hipFuncSetAttribute((const void*)mk_fwd, hipFuncAttributeMaxDynamicSharedMemorySize, LDS_BYTES) != hipSuccess) { fprintf(stderr, "kernel_launch: hipFuncSetAttribute failed\n"); grid = -1; return; }
        if (hipOccupancyMaxActiveBlocksPerMultiprocessor(&per_cu, (const void*)mk_fwd, NWAVES * 64, LDS_BYTES) != hipSuccess || per_cu < 1) { fprintf(stderr, "kernel_launch: occupancy query says %d\n", per_cu); per_cu = 1; }
        (void)hipGetLastError();
        grid = cus;
    }
    if (grid < 0) return;
    (void)hipMemsetAsync((char*)d_ws + WS_CTL, 0, CTL_ZERO_BYTES, stream);
    Args a{};
    const float** pp = (const float**)&a.p;
    for (int i = 0; i < 22; ++i) pp[i] = (const float*)d_in[i];
    a.p.out = (float*)d_out; a.p.ws = (unsigned char*)d_ws;
    if (N_LAUNCHES == 1) { a.ph_lo = 0; a.ph_hi = NPHASE; a.li = 0; hipLaunchKernelGGL(mk_fwd, dim3(grid), dim3(NWAVES * 64), LDS_BYTES, stream, a); }
    else { for (int li = 0; li < NPHASE; ++li) { a.ph_lo = li; a.ph_hi = li + 1; a.li = li; hipLaunchKernelGGL(mk_fwd, dim3(grid), dim3(NWAVES * 64), LDS_BYTES, stream, a); } }
}
```
